# Optimizing an MI355X kernel written in HIP

```python
import math
import jax, jax.numpy as jnp
from jax import lax
import numpy as np

D_MODEL = 1024
BATCH = 8
SEQ = 4096
DEPTH = 2

D_MIX = D_MODEL
D_DIFF = D_MIX // 2
D_RWKV = D_MIX - D_DIFF
DIFF_HEADS = 4
DIFF_HEAD_DIM = D_DIFF // DIFF_HEADS // 2
DIFF_V_DIM = 2 * DIFF_HEAD_DIM
RWKV_HEAD = 64
RWKV_HEADS = D_RWKV // RWKV_HEAD
LORA_W = 64
LORA_A = 64
LORA_V = 32
LORA_G = 160
D_FF = 4 * D_MODEL
N_BUCKETS = 32
MAX_DISTANCE = 128
Q_BLOCK = 128
LN_EPS = 1e-5
SUBLN_EPS = 1e-5
GN_EPS = 64e-5
ALPHA = (2 * DEPTH) ** 0.25
BETA = (8 * DEPTH) ** -0.25

N_DIFF = 3 * D_DIFF
RW_R = 0
RW_K = D_RWKV
RW_V = 2 * D_RWKV
RW_W = 3 * D_RWKV
RW_A = RW_W + LORA_W
RW_G = RW_A + LORA_A
N_RWKV_BASE = RW_G + LORA_G
N_RWKV_REST = N_RWKV_BASE + LORA_V
N_IN_FIRST = N_DIFF + N_RWKV_BASE
N_IN_REST = N_DIFF + N_RWKV_REST

kernel_name = "hybrid_diffattn_rwkv7_deepnorm"


def layer_norm(x, g, b, eps=LN_EPS):
    xf = x.astype(jnp.float32)
    mu = jnp.mean(xf, -1, keepdims=True)
    var = jnp.mean(jnp.square(xf - mu), -1, keepdims=True)
    return ((xf - mu) * lax.rsqrt(var + eps) * g + b).astype(x.dtype)


def t5_causal_bucket(dist):
    n = jnp.maximum(dist, 0)
    max_exact = N_BUCKETS // 2
    nf = jnp.maximum(n, 1).astype(jnp.float32)
    large = max_exact + (jnp.log(nf / max_exact) / math.log(MAX_DISTANCE / max_exact)
                         * (N_BUCKETS - max_exact)).astype(jnp.int32)
    large = jnp.minimum(large, N_BUCKETS - 1)
    return jnp.where(n < max_exact, n, large)


def diff_attention(q, k, v, rel_bias, lam, subln_g, lam_init):
    B, S = q.shape[0], q.shape[1]
    nb = S // Q_BLOCK
    scale = DIFF_HEAD_DIM ** -0.5
    qb = (q * scale).reshape(B, nb, Q_BLOCK, DIFF_HEADS, 2, DIFF_HEAD_DIM)
    qb = qb.transpose(1, 0, 3, 4, 2, 5)
    kt = k.transpose(0, 2, 3, 1, 4)
    vt = v.transpose(0, 2, 1, 3)
    k_pos = jnp.arange(S, dtype=jnp.int32)

    def block(args):
        q_blk, idx = args
        q_pos = idx * Q_BLOCK + jnp.arange(Q_BLOCK, dtype=jnp.int32)
        dist = q_pos[:, None] - k_pos[None, :]
        bias = jnp.transpose(rel_bias[t5_causal_bucket(dist)], (2, 0, 1)).astype(jnp.float32)
        logits = jnp.einsum('bhmqd,bhmkd->bhmqk', q_blk, kt).astype(jnp.float32)
        logits = logits + bias[None, :, None]
        logits = jnp.where((dist >= 0)[None, None, None], logits, -jnp.inf)
        probs = jax.nn.softmax(logits, axis=-1)
        attn = probs[:, :, 0] - lam * probs[:, :, 1]
        return jnp.einsum('bhqk,bhkd->bhqd', attn.astype(vt.dtype), vt)

    out = lax.map(block, (qb, jnp.arange(nb, dtype=jnp.int32)))
    out = out.transpose(1, 0, 3, 2, 4).reshape(B, S, DIFF_HEADS, DIFF_V_DIM).astype(jnp.float32)
    out = out * lax.rsqrt(jnp.mean(jnp.square(out), -1, keepdims=True) + SUBLN_EPS) * subln_g
    out = out * (1.0 - lam_init)
    return out.reshape(B, S, D_DIFF)


def wkv7_scan(r, w, k, v, a, b):
    B, _, H, N = r.shape

    def step(state, inp):
        r_t, w_t, k_t, v_t, a_t, b_t = inp
        sa = jnp.einsum('bhij,bhj->bhi', state, a_t)
        state = (state * w_t[:, :, None, :] + sa[..., None] * b_t[:, :, None, :]
                 + v_t[..., None] * k_t[:, :, None, :])
        y = jnp.einsum('bhij,bhj->bhi', state, r_t)
        return state, y

    xs = tuple(jnp.moveaxis(t, 1, 0) for t in (r, w, k, v, a, b))
    s0 = jnp.zeros((B, H, N, N), jnp.float32)
    _, ys = lax.scan(step, s0, xs)
    return jnp.moveaxis(ys, 0, 1)


def rwkv7_time_mix(r, k, v, xw, xa, xg, w0, w_up, a0, a_up, g_up, k_k, k_a, r_k, gn_g, gn_b):
    B, S, _ = r.shape
    f32 = jnp.float32
    r, k, v, xw, xa, xg = (t.astype(f32) for t in (r, k, v, xw, xa, xg))
    w = -jax.nn.softplus(-(w0 + jnp.tanh(xw) @ w_up)) - 0.5
    decay = jnp.exp(-jnp.exp(w))
    a = jax.nn.sigmoid(a0 + xa @ a_up)
    g = jax.nn.sigmoid(xg) @ g_up
    heads = lambda t: t.reshape(B, S, RWKV_HEADS, RWKV_HEAD)
    kk = heads(k * k_k)
    kk = kk / jnp.maximum(jnp.sqrt(jnp.sum(jnp.square(kk), -1, keepdims=True)), 1e-12)
    k = k * (1.0 + (a - 1.0) * k_a)
    rh, kh, vh, ah = heads(r), heads(k), heads(v), heads(a)
    y = wkv7_scan(rh, heads(decay), kh, vh, -kk, kk * ah)
    mu = jnp.mean(y, -1, keepdims=True)
    var = jnp.mean(jnp.square(y - mu), -1, keepdims=True)
    y = ((y - mu) * lax.rsqrt(var + GN_EPS)).reshape(B, S, D_RWKV) * gn_g + gn_b
    bonus = jnp.sum(rh * kh * r_k, -1, keepdims=True) * vh
    return (y + bonus.reshape(B, S, D_RWKV)) * g


def setup_inputs(seed: int = 0) -> dict:
    key = jax.random.key(seed)
    ks = iter(jax.random.split(key, 48))
    f32 = jnp.float32
    nrm = lambda shape, s: jax.random.normal(next(ks), shape, f32) * s
    uni = lambda shape, lo, hi: jax.random.uniform(next(ks), shape, f32, lo, hi)

    def in_col_scale(n):
        s = np.ones((n,), np.float32)
        s[2 * D_DIFF:3 * D_DIFF] = BETA
        s[N_DIFF + RW_V:N_DIFF + RW_V + D_RWKV] = BETA
        return jnp.asarray(s)

    D = D_MODEL
    return {
        "x": nrm((BATCH, SEQ, D), 1.0),
        "ln_in_g": 1.0 + nrm((D,), 0.02),
        "ln_in_b": nrm((D,), 0.02),
        "w_in_first": nrm((D, N_IN_FIRST), D ** -0.5) * in_col_scale(N_IN_FIRST),
        "w_in_rest": nrm((DEPTH - 1, D, N_IN_REST), D ** -0.5) * in_col_scale(N_IN_REST),
        "mu_first": uni((N_RWKV_BASE,), 0.1, 0.9),
        "mu_rest": uni((DEPTH - 1, N_RWKV_REST), 0.1, 0.9),
        "rel_bias": nrm((N_BUCKETS, DIFF_HEADS), 0.5),
        "lambda_q1": nrm((DEPTH, DIFF_HEAD_DIM), 0.1),
        "lambda_k1": nrm((DEPTH, DIFF_HEAD_DIM), 0.1),
        "lambda_q2": nrm((DEPTH, DIFF_HEAD_DIM), 0.1),
        "lambda_k2": nrm((DEPTH, DIFF_HEAD_DIM), 0.1),
        "subln_g": 1.0 + nrm((DEPTH, DIFF_V_DIM), 0.02),
        "rw_w0": uni((DEPTH, D_RWKV), -6.0, -0.5),
        "rw_w_up": nrm((DEPTH, LORA_W, D_RWKV), 0.1),
        "rw_a0": nrm((DEPTH, D_RWKV), 0.1),
        "rw_a_up": nrm((DEPTH, LORA_A, D_RWKV), 0.1),
        "rw_g_up": nrm((DEPTH, LORA_G, D_RWKV), LORA_G ** -0.5),
        "rw_v0": uni((DEPTH - 1, D_RWKV), 0.5, 1.5),
        "rw_v_up": nrm((DEPTH - 1, LORA_V, D_RWKV), 0.1),
        "rw_k_k": 0.85 + nrm((DEPTH, D_RWKV), 0.05),
        "rw_k_a": 1.0 + nrm((DEPTH, D_RWKV), 0.05),
        "rw_r_k": nrm((DEPTH, RWKV_HEADS, RWKV_HEAD), 0.1),
        "rw_gn_g": 1.0 + nrm((DEPTH, D_RWKV), 0.02),
        "rw_gn_b": nrm((DEPTH, D_RWKV), 0.02),
        "w_out": nrm((DEPTH, D_MIX, D), D_MIX ** -0.5 * BETA),
        "ln_mix_g": 1.0 + nrm((DEPTH, D), 0.02),
        "ln_mix_b": nrm((DEPTH, D), 0.02),
        "w_up": nrm((DEPTH, D, D_FF), D ** -0.5 * BETA),
        "w_down": nrm((DEPTH, D_FF, D), D_FF ** -0.5 * BETA),
        "ln_ffn_g": 1.0 + nrm((DEPTH, D), 0.02),
        "ln_ffn_b": nrm((DEPTH, D), 0.02),
    }


def reference(x, ln_in_g, ln_in_b, w_in_first, w_in_rest, mu_first, mu_rest, rel_bias,
              lambda_q1, lambda_k1, lambda_q2, lambda_k2, subln_g,
              rw_w0, rw_w_up, rw_a0, rw_a_up, rw_g_up, rw_v0, rw_v_up,
              rw_k_k, rw_k_a, rw_r_k, rw_gn_g, rw_gn_b,
              w_out, ln_mix_g, ln_mix_b, w_up, w_down, ln_ffn_g, ln_ffn_b):
    B, S, _ = x.shape
    f32 = jnp.float32
    x = layer_norm(x, ln_in_g, ln_in_b)
    v_first = None
    for l in range(DEPTH):
        w_in = w_in_first if l == 0 else w_in_rest[l - 1]
        mu = mu_first if l == 0 else mu_rest[l - 1]
        p = jnp.einsum('bsd,dn->bsn', x, w_in)

        q = p[..., 0:D_DIFF].reshape(B, S, DIFF_HEADS, 2, DIFF_HEAD_DIM)
        k = p[..., D_DIFF:2 * D_DIFF].reshape(B, S, DIFF_HEADS, 2, DIFF_HEAD_DIM)
        v = p[..., 2 * D_DIFF:N_DIFF].reshape(B, S, DIFF_HEADS, DIFF_V_DIM)
        lam_init = 0.8 - 0.6 * math.exp(-0.3 * l)
        lam = (jnp.exp(jnp.sum(lambda_q1[l] * lambda_k1[l]).astype(f32))
               - jnp.exp(jnp.sum(lambda_q2[l] * lambda_k2[l]).astype(f32)) + lam_init)
        y_diff = diff_attention(q, k, v, rel_bias, lam, subln_g[l], lam_init)

        pr = p[..., N_DIFF:]
        pr_prev = jnp.pad(pr, ((0, 0), (1, 0), (0, 0)))[:, :-1]
        pr = pr + (pr_prev - pr) * mu
        r_rw = pr[..., RW_R:RW_R + D_RWKV]
        k_rw = pr[..., RW_K:RW_K + D_RWKV]
        v_rw = pr[..., RW_V:RW_V + D_RWKV].astype(f32)
        if l == 0:
            v_first = v_rw
        else:
            xv = pr[..., N_RWKV_BASE:N_RWKV_REST].astype(f32)
            v_rw = v_rw + (v_first - v_rw) * jax.nn.sigmoid(rw_v0[l - 1] + xv @ rw_v_up[l - 1])
        y_rw = rwkv7_time_mix(r_rw, k_rw, v_rw,
                              pr[..., RW_W:RW_A], pr[..., RW_A:RW_G], pr[..., RW_G:N_RWKV_BASE],
                              rw_w0[l], rw_w_up[l], rw_a0[l], rw_a_up[l], rw_g_up[l],
                              rw_k_k[l], rw_k_a[l], rw_r_k[l], rw_gn_g[l], rw_gn_b[l])

        mix = jnp.concatenate([y_diff.astype(x.dtype), y_rw.astype(x.dtype)], axis=-1)
        mix = jnp.einsum('bsm,md->bsd', mix, w_out[l])
        x = layer_norm(ALPHA * x + mix, ln_mix_g[l], ln_mix_b[l])

        h = jnp.square(jax.nn.relu(jnp.einsum('bsd,df->bsf', x, w_up[l])))
        h = jnp.einsum('bsf,fd->bsd', h, w_down[l])
        x = layer_norm(ALPHA * x + h, ln_ffn_g[l], ln_ffn_b[l])
    return x
```

```cpp
#include <hip/hip_runtime.h>
#include <stdint.h>
#include <math.h>

typedef unsigned short bf16_t;
#define DEVI __device__ __forceinline__

DEVI float bf2f(bf16_t v) { return __uint_as_float(((unsigned)v) << 16); }
DEVI bf16_t f2bf(float f) { unsigned u = __float_as_uint(f); return (bf16_t)((u + 0x7fffu + ((u >> 16) & 1u)) >> 16); }
DEVI float wave_sum(float v) {
#pragma unroll
    for (int o = 1; o < 64; o <<= 1) v += __shfl_xor(v, o);
    return v;
}
DEVI float sigmoidf_(float x) { return 1.0f / (1.0f + expf(-x)); }

constexpr int BATCH = 8, SEQ = 4096, DM = 1024, MTOK = BATCH * SEQ;
constexpr int NPAD = 3584;
constexpr int N_DIFF = 1536, NRW0 = 1824, NRW1 = 1856;
constexpr int DFF = 4096;
constexpr float QSCALE = 0.125f * 1.4426950408889634f;
constexpr float LOG2E = 1.4426950408889634f;
constexpr float ALPHA = 1.4142135623730951f;

constexpr size_t MiB = 1u << 20;
constexpr size_t WS_SMALL = 1 * MiB;
constexpr size_t WS_WIN = 2 * MiB;
constexpr size_t WS_WOUT = 16 * MiB;
constexpr size_t WS_WUP = 20 * MiB;
constexpr size_t WS_WDOWN = 36 * MiB;
constexpr size_t WS_XB = 64 * MiB;
constexpr size_t WS_VFIRST = 128 * MiB;
constexpr size_t WS_P = 160 * MiB;
constexpr size_t WS_MIXIN = 384 * MiB;
constexpr size_t WS_HID = 160 * MiB;
constexpr size_t WS_END = 448 * MiB;

__device__ const unsigned char kBucket[128] = {
    0, 1, 2, 3, 4, 5, 6, 7, 8, 9, 10, 11, 12, 13, 14, 15, 16, 16, 16, 17, 17, 18, 18, 18, 19, 19, 19, 20, 20, 20, 20, 21, 21, 21, 21, 22, 22, 22, 22, 22, 23, 23, 23, 23, 23, 23, 24,
    24, 24, 24, 24, 24, 25, 25, 25, 25, 25, 25, 25, 26, 26, 26, 26, 26, 26, 26, 26, 27, 27, 27, 27, 27, 27, 27, 27, 27, 27, 28, 28, 28, 28, 28, 28, 28, 28, 28, 28, 29, 29, 29, 29, 29, 29,
    29, 29, 29, 29, 29, 29, 30, 30, 30, 30, 30, 30, 30, 30, 30, 30, 30, 30, 30, 30, 31, 31, 31, 31, 31, 31, 31, 31, 31, 31, 31, 31, 31, 31, 31};

__global__ void k_small(const float* rel_bias, const float* lq1, const float* lk1, const float* lq2, const float* lk2, float* small) {
    const int tid = threadIdx.x;
    if (tid < 2) {
        float s1 = 0.f, s2 = 0.f;
        for (int i = 0; i < 64; ++i) { s1 += lq1[tid * 64 + i] * lk1[tid * 64 + i]; s2 += lq2[tid * 64 + i] * lk2[tid * 64 + i]; }
        const float lam_init = (tid == 0) ? 0.2f : (float)(0.8 - 0.6 * 0.7408182206817179);
        small[tid] = expf(s1) - expf(s2) + lam_init;
        small[2 + tid] = lam_init;
    }
    for (int i = tid; i < 512; i += blockDim.x) { const int h = i >> 7, d = i & 127; small[64 + i] = rel_bias[kBucket[d] * 4 + h] * LOG2E; }
}

__global__ void k_wt(const float* W, int K, int N, bf16_t* WT) {
    __shared__ float t[32][33];
    const int n0 = blockIdx.x * 32, k0 = blockIdx.y * 32, tx = threadIdx.x & 31, ty = threadIdx.x >> 5;
    for (int i = ty; i < 32; i += 8) { const int n = n0 + tx; t[i][tx] = (n < N) ? W[(size_t)(k0 + i) * N + n] : 0.f; }
    __syncthreads();
    for (int i = ty; i < 32; i += 8) WT[(size_t)(n0 + i) * K + k0 + tx] = f2bf(t[tx][i]);
}

__global__ void k_ln(const float* in, const float* g, const float* b, float* outf, bf16_t* outb) {
    const int row = blockIdx.x * 4 + (threadIdx.x >> 6), lane = threadIdx.x & 63;
    const float4* xr = (const float4*)(in + (size_t)row * DM);
    float4 v[4]; float s = 0.f;
#pragma unroll
    for (int j = 0; j < 4; ++j) { v[j] = xr[lane + 64 * j]; s += (v[j].x + v[j].y) + (v[j].z + v[j].w); }
    const float mean = wave_sum(s) * (1.f / DM); float s2 = 0.f;
#pragma unroll
    for (int j = 0; j < 4; ++j) { v[j].x -= mean; v[j].y -= mean; v[j].z -= mean; v[j].w -= mean; s2 += (v[j].x * v[j].x + v[j].y * v[j].y) + (v[j].z * v[j].z + v[j].w * v[j].w); }
    const float rstd = 1.0f / sqrtf(wave_sum(s2) * (1.f / DM) + 1e-5f);
#pragma unroll
    for (int j = 0; j < 4; ++j) {
        const int c = (lane + 64 * j) * 4;
        const float4 gg = *(const float4*)(g + c), bb = *(const float4*)(b + c);
        float4 o; o.x = v[j].x * rstd * gg.x + bb.x; o.y = v[j].y * rstd * gg.y + bb.y; o.z = v[j].z * rstd * gg.z + bb.z; o.w = v[j].w * rstd * gg.w + bb.w;
        *(float4*)(outf + (size_t)row * DM + c) = o;
        if (outb) { ushort4 w; w.x = f2bf(o.x); w.y = f2bf(o.y); w.z = f2bf(o.z); w.w = f2bf(o.w); *(ushort4*)(outb + (size_t)row * DM + c) = w; }
    }
}

template <int MODE>
__global__ __launch_bounds__(256) void k_gemm(const bf16_t* A, const bf16_t* Bt, int K, void* out, int ldc, int nvalid) {
    __shared__ float As[32][68], Bs[32][68];
    const int tid = threadIdx.x, tx = tid & 15, ty = tid >> 4, lr = tid & 63, ks = (tid >> 6) * 8;
    const int m0 = blockIdx.y * 64, n0 = blockIdx.x * 64;
    float acc[4][4];
#pragma unroll
    for (int i = 0; i < 4; ++i)
#pragma unroll
        for (int j = 0; j < 4; ++j) acc[i][j] = 0.f;
    for (int k0 = 0; k0 < K; k0 += 32) {
        const uint4 av = *(const uint4*)(A + (size_t)(m0 + lr) * K + k0 + ks);
        const uint4 bv = *(const uint4*)(Bt + (size_t)(n0 + lr) * K + k0 + ks);
        const unsigned aw[4] = {av.x, av.y, av.z, av.w}, bw[4] = {bv.x, bv.y, bv.z, bv.w};
#pragma unroll
        for (int i = 0; i < 4; ++i) {
            As[ks + 2 * i][lr] = __uint_as_float(aw[i] << 16); As[ks + 2 * i + 1][lr] = __uint_as_float(aw[i] & 0xffff0000u);
            Bs[ks + 2 * i][lr] = __uint_as_float(bw[i] << 16); Bs[ks + 2 * i + 1][lr] = __uint_as_float(bw[i] & 0xffff0000u);
        }
        __syncthreads();
#pragma unroll 8
        for (int kk = 0; kk < 32; ++kk) {
            const float4 a4 = *(const float4*)&As[kk][ty * 4], b4 = *(const float4*)&Bs[kk][tx * 4];
            const float a[4] = {a4.x, a4.y, a4.z, a4.w}, b[4] = {b4.x, b4.y, b4.z, b4.w};
#pragma unroll
            for (int i = 0; i < 4; ++i)
#pragma unroll
                for (int j = 0; j < 4; ++j) acc[i][j] += a[i] * b[j];
        }
        __syncthreads();
    }
#pragma unroll
    for (int i = 0; i < 4; ++i) {
        const int row = m0 + ty * 4 + i;
#pragma unroll
        for (int j = 0; j < 4; ++j) {
            const int col = n0 + tx * 4 + j; const float v = acc[i][j];
            if (MODE == 0) { if (col < nvalid) ((bf16_t*)out)[(size_t)row * ldc + col] = f2bf(col < 512 ? v * QSCALE : v); }
            else if (MODE == 1) { const float r = fmaxf(v, 0.f); ((bf16_t*)out)[(size_t)row * ldc + col] = f2bf(r * r); }
            else { float* p = (float*)out + (size_t)row * ldc + col; *p = ALPHA * (*p) + v; }
        }
    }
}

__global__ __launch_bounds__(64) void k_attn_stats(const bf16_t* P, const float* small, float* stats) {
    __shared__ float Ks[64][68];
    __shared__ float sb[128];
    const int qb = blockIdx.x, hm = blockIdx.y, b = blockIdx.z, tid = threadIdx.x, h = hm >> 1;
    const int qpos = qb * 64 + tid; const size_t tok = (size_t)b * SEQ + qpos;
    sb[tid] = small[64 + h * 128 + tid]; sb[tid + 64] = small[64 + h * 128 + 64 + tid];
    float q[64];
    { const bf16_t* qp = P + tok * NPAD + hm * 64;
#pragma unroll
      for (int d = 0; d < 64; ++d) q[d] = bf2f(qp[d]); }
    float m = -INFINITY, l = 0.f;
    for (int kt = 0; kt <= qb; ++kt) {
        __syncthreads();
        { const bf16_t* kp = P + ((size_t)b * SEQ + kt * 64 + tid) * NPAD + 512 + hm * 64;
#pragma unroll
          for (int d = 0; d < 64; ++d) Ks[tid][d] = bf2f(kp[d]); }
        __syncthreads();
        for (int key = 0; key < 64; ++key) {
            float s = 0.f;
#pragma unroll
            for (int d = 0; d < 64; d += 4) { const float4 k4 = *(const float4*)&Ks[key][d]; s += q[d] * k4.x + q[d + 1] * k4.y + q[d + 2] * k4.z + q[d + 3] * k4.w; }
            const int dist = qpos - (kt * 64 + key);
            if (dist >= 0) { s += sb[dist < 127 ? dist : 127]; const float mn = fmaxf(m, s); l = l * exp2f(m - mn) + exp2f(s - mn); m = mn; }
        }
    }
    stats[(tok * 8 + hm) * 2] = m; stats[(tok * 8 + hm) * 2 + 1] = l;
}
__global__ __launch_bounds__(64) void k_attn_out(const bf16_t* P, const float* small, const float* stats, float* raw, int layer) {
    __shared__ float K1[64][68], K2[64][68], Vs[64][36];
    __shared__ float sb[128];
    const int qb = blockIdx.x, h = blockIdx.y >> 2, ch = blockIdx.y & 3, b = blockIdx.z, tid = threadIdx.x;
    const int qpos = qb * 64 + tid; const size_t tok = (size_t)b * SEQ + qpos;
    sb[tid] = small[64 + h * 128 + tid]; sb[tid + 64] = small[64 + h * 128 + 64 + tid];
    const float lam = small[layer];
    float q1[64], q2[64], O[32];
    { const bf16_t* qp = P + tok * NPAD + h * 128;
#pragma unroll
      for (int d = 0; d < 64; ++d) { q1[d] = bf2f(qp[d]); q2[d] = bf2f(qp[64 + d]); } }
#pragma unroll
    for (int j = 0; j < 32; ++j) O[j] = 0.f;
    const float m1 = stats[(tok * 8 + h * 2) * 2], il1 = 1.0f / stats[(tok * 8 + h * 2) * 2 + 1];
    const float m2 = stats[(tok * 8 + h * 2 + 1) * 2], il2 = lam / stats[(tok * 8 + h * 2 + 1) * 2 + 1];
    for (int kt = 0; kt <= qb; ++kt) {
        __syncthreads();
        { const bf16_t* kp = P + ((size_t)b * SEQ + kt * 64 + tid) * NPAD;
#pragma unroll
          for (int d = 0; d < 64; ++d) { K1[tid][d] = bf2f(kp[512 + h * 128 + d]); K2[tid][d] = bf2f(kp[512 + h * 128 + 64 + d]); }
#pragma unroll
          for (int d = 0; d < 32; ++d) Vs[tid][d] = bf2f(kp[1024 + h * 128 + ch * 32 + d]); }
        __syncthreads();
        for (int key = 0; key < 64; ++key) {
            const int dist = qpos - (kt * 64 + key);
            float s1 = 0.f, s2 = 0.f;
#pragma unroll
            for (int d = 0; d < 64; d += 4) {
                const float4 a4 = *(const float4*)&K1[key][d], b4 = *(const float4*)&K2[key][d];
                s1 += q1[d] * a4.x + q1[d + 1] * a4.y + q1[d + 2] * a4.z + q1[d + 3] * a4.w;
                s2 += q2[d] * b4.x + q2[d + 1] * b4.y + q2[d + 2] * b4.z + q2[d + 3] * b4.w;
            }
            float a = 0.f;
            if (dist >= 0) { const float bb = sb[dist < 127 ? dist : 127]; a = exp2f(s1 + bb - m1) * il1 - exp2f(s2 + bb - m2) * il2; }
#pragma unroll
            for (int j = 0; j < 32; j += 4) { const float4 v4 = *(const float4*)&Vs[key][j]; O[j] += a * v4.x; O[j + 1] += a * v4.y; O[j + 2] += a * v4.z; O[j + 3] += a * v4.w; }
        }
    }
    float* rp = raw + (tok * 4 + h) * 128 + ch * 32;
#pragma unroll
    for (int j = 0; j < 32; ++j) rp[j] = O[j];
}
__global__ void k_subln(const float* raw, const float* small, const float* subln_g, bf16_t* mixin, int layer) {
    const int idx = blockIdx.x * 4 + (threadIdx.x >> 6), lane = threadIdx.x & 63;
    const int tok = idx >> 2, h = idx & 3;
    const float x0 = raw[(size_t)idx * 128 + lane], x1 = raw[(size_t)idx * 128 + 64 + lane];
    const float ms = wave_sum(x0 * x0 + x1 * x1) * (1.f / 128.f);
    const float sc = (1.0f / sqrtf(ms + 1e-5f)) * (1.0f - small[2 + layer]);
    mixin[(size_t)tok * DM + h * 128 + lane] = f2bf(x0 * sc * subln_g[layer * 128 + lane]);
    mixin[(size_t)tok * DM + h * 128 + 64 + lane] = f2bf(x1 * sc * subln_g[layer * 128 + 64 + lane]);
}

struct RwParams {
    const float *mu, *w0, *w_up, *a0, *a_up, *g_up, *v0, *v_up, *k_k, *k_a, *r_k, *gn_g, *gn_b;
};
constexpr size_t RW_ARR = (size_t)SEQ * 512;
template <int LAYER>
__global__ __launch_bounds__(512) void k_rw_prep(const bf16_t* P, bf16_t* vfirst, RwParams rp, float* scr, int b) {
    constexpr int NL = LAYER ? 352 : 320;
    __shared__ float act[NL][32];
    const int tid = threadIdx.x, c = tid, t0 = blockIdx.x * 32;
    const size_t tokbase = (size_t)b * SEQ + t0;
    for (int idx = tid; idx < NL * 32; idx += 512) {
        const int tok = idx & 31, j = idx >> 5, col = N_DIFF + 1536 + j;
        const float cur = bf2f(P[(tokbase + tok) * NPAD + col]);
        const float prev = (t0 + tok > 0) ? bf2f(P[(tokbase + tok - 1) * NPAD + col]) : 0.f;
        float v = cur + (prev - cur) * rp.mu[1536 + j];
        if (j < 64) v = tanhf(v); else if (j >= 128 && j < 288) v = sigmoidf_(v);
        act[j][tok] = v;
    }
    __syncthreads();
    float acc[32], av[32];
#pragma unroll
    for (int t = 0; t < 32; ++t) acc[t] = 0.f;
    for (int j = 0; j < 64; ++j) { const float w = rp.a_up[j * 512 + c];
#pragma unroll
        for (int t = 0; t < 32; t += 4) { const float4 x = *(const float4*)&act[64 + j][t]; acc[t] += x.x * w; acc[t + 1] += x.y * w; acc[t + 2] += x.z * w; acc[t + 3] += x.w * w; } }
    { const float a0 = rp.a0[c];
#pragma unroll
      for (int t = 0; t < 32; ++t) av[t] = sigmoidf_(a0 + acc[t]); }
#pragma unroll
    for (int t = 0; t < 32; ++t) acc[t] = 0.f;
    for (int j = 0; j < 64; ++j) { const float w = rp.w_up[j * 512 + c];
#pragma unroll
        for (int t = 0; t < 32; t += 4) { const float4 x = *(const float4*)&act[j][t]; acc[t] += x.x * w; acc[t + 1] += x.y * w; acc[t + 2] += x.z * w; acc[t + 3] += x.w * w; } }
    { const float w0 = rp.w0[c];
#pragma unroll
      for (int t = 0; t < 32; ++t) {
          const float z = -(w0 + acc[t]);
          const float sp = fmaxf(z, 0.f) + log1pf(expf(-fabsf(z)));
          const float wr = -sp - 0.5f;
          scr[1 * RW_ARR + (size_t)(t0 + t) * 512 + c] = expf(-expf(wr));
      } }
#pragma unroll
    for (int t = 0; t < 32; ++t) acc[t] = 0.f;
    for (int j = 0; j < 160; ++j) { const float w = rp.g_up[j * 512 + c];
#pragma unroll
        for (int t = 0; t < 32; t += 4) { const float4 x = *(const float4*)&act[128 + j][t]; acc[t] += x.x * w; acc[t + 1] += x.y * w; acc[t + 2] += x.z * w; acc[t + 3] += x.w * w; } }
#pragma unroll
    for (int t = 0; t < 32; ++t) scr[6 * RW_ARR + (size_t)(t0 + t) * 512 + c] = acc[t];
    if (LAYER) {
#pragma unroll
        for (int t = 0; t < 32; ++t) acc[t] = 0.f;
        for (int j = 0; j < 32; ++j) { const float w = rp.v_up[j * 512 + c];
#pragma unroll
            for (int t = 0; t < 32; t += 4) { const float4 x = *(const float4*)&act[288 + j][t]; acc[t] += x.x * w; acc[t + 1] += x.y * w; acc[t + 2] += x.z * w; acc[t + 3] += x.w * w; } }
        const float v0 = rp.v0[c];
#pragma unroll
        for (int t = 0; t < 32; ++t) acc[t] = sigmoidf_(v0 + acc[t]);
    }
    const float mur = rp.mu[c], muk = rp.mu[512 + c], muv = rp.mu[1024 + c], kkc = rp.k_k[c], kac = rp.k_a[c], rkc = rp.r_k[c];
    const int h = c >> 6;
#pragma unroll 4
    for (int t = 0; t < 32; ++t) {
        const bf16_t* pc = P + (tokbase + t) * NPAD + N_DIFF; const bool has = (t0 + t > 0);
        const float rc = bf2f(pc[c]), kc = bf2f(pc[512 + c]), vc = bf2f(pc[1024 + c]);
        const float rpv = has ? bf2f(pc[c - NPAD]) : 0.f, kpv = has ? bf2f(pc[512 + c - NPAD]) : 0.f, vpv = has ? bf2f(pc[1024 + c - NPAD]) : 0.f;
        const float r = rc + (rpv - rc) * mur, k = kc + (kpv - kc) * muk; float v = vc + (vpv - vc) * muv;
        if (LAYER == 0) vfirst[(tokbase + t) * 512 + c] = f2bf(v);
        else { const float vf = bf2f(vfirst[(tokbase + t) * 512 + c]); v = v + (vf - v) * acc[t]; }
        float kk = k * kkc; const float nrm = sqrtf(wave_sum(kk * kk)); kk = kk / fmaxf(nrm, 1e-12f);
        const float a = av[t], k2 = k * (1.0f + (a - 1.0f) * kac);
        const float bon = wave_sum(r * k2 * rkc);
        const size_t o = (size_t)(t0 + t) * 512 + c;
        scr[0 * RW_ARR + o] = r; scr[2 * RW_ARR + o] = k2; scr[3 * RW_ARR + o] = v; scr[4 * RW_ARR + o] = kk; scr[5 * RW_ARR + o] = kk * a;
        if ((tid & 63) == 0) scr[7 * RW_ARR + (size_t)(t0 + t) * 8 + h] = bon;
    }
}
__global__ __launch_bounds__(64) void k_rw_scan(const float* scr, const float* gn_g, const float* gn_b, bf16_t* mixin, int b) {
    __shared__ float vec[5][16][64];
    const int h = blockIdx.x, i = threadIdx.x, c = h * 64 + i;
    float S[64];
#pragma unroll
    for (int j = 0; j < 64; ++j) S[j] = 0.f;
    const float gg = gn_g[c], gb = gn_b[c];
    for (int t0 = 0; t0 < SEQ; t0 += 16) {
        __syncthreads();
#pragma unroll
        for (int s = 0; s < 16; ++s) {
            const size_t o = (size_t)(t0 + s) * 512 + c;
            vec[0][s][i] = -scr[4 * RW_ARR + o]; vec[1][s][i] = scr[1 * RW_ARR + o]; vec[2][s][i] = scr[5 * RW_ARR + o]; vec[3][s][i] = scr[2 * RW_ARR + o]; vec[4][s][i] = scr[0 * RW_ARR + o];
        }
        __syncthreads();
        for (int s = 0; s < 16; ++s) {
            const size_t o = (size_t)(t0 + s) * 512 + c;
            const float v = scr[3 * RW_ARR + o];
            float sa = 0.f;
#pragma unroll
            for (int j = 0; j < 64; j += 4) { const float4 a4 = *(const float4*)&vec[0][s][j]; sa += S[j] * a4.x + S[j + 1] * a4.y + S[j + 2] * a4.z + S[j + 3] * a4.w; }
            float y = 0.f;
#pragma unroll
            for (int j = 0; j < 64; j += 4) {
                const float4 w4 = *(const float4*)&vec[1][s][j], b4 = *(const float4*)&vec[2][s][j], k4 = *(const float4*)&vec[3][s][j], r4 = *(const float4*)&vec[4][s][j];
                S[j] = S[j] * w4.x + sa * b4.x + v * k4.x; S[j + 1] = S[j + 1] * w4.y + sa * b4.y + v * k4.y;
                S[j + 2] = S[j + 2] * w4.z + sa * b4.z + v * k4.z; S[j + 3] = S[j + 3] * w4.w + sa * b4.w + v * k4.w;
                y += S[j] * r4.x + S[j + 1] * r4.y + S[j + 2] * r4.z + S[j + 3] * r4.w;
            }
            const float mu = wave_sum(y) * (1.f / 64.f), d = y - mu, var = wave_sum(d * d) * (1.f / 64.f);
            const float yn = d * (1.0f / sqrtf(var + 64e-5f)) * gg + gb;
            const float bon = scr[7 * RW_ARR + (size_t)(t0 + s) * 8 + h], g = scr[6 * RW_ARR + o];
            mixin[((size_t)b * SEQ + t0 + s) * DM + 512 + c] = f2bf((yn + bon * v) * g);
        }
    }
}

constexpr size_t WS_STATS = 56 * MiB;
extern "C" void kernel_launch(void* const* d_in, const int* in_sizes, int n_in, void* d_out, int out_size, void* d_ws, size_t ws_size, hipStream_t stream) {
    if (n_in != 32 || ws_size < WS_END) return;
    const float* const* in = (const float* const*)d_in;
    unsigned char* ws = (unsigned char*)d_ws;
    float* small = (float*)(ws + WS_SMALL);
    float* stats = (float*)(ws + WS_STATS);
    bf16_t* XB = (bf16_t*)(ws + WS_XB); float* SCR = (float*)(ws + WS_XB);
    bf16_t* VF = (bf16_t*)(ws + WS_VFIRST); bf16_t* P = (bf16_t*)(ws + WS_P); bf16_t* MIX = (bf16_t*)(ws + WS_MIXIN); bf16_t* HID = (bf16_t*)(ws + WS_HID);
    float* xres = (float*)d_out;
    bf16_t* WIN[2] = {(bf16_t*)(ws + WS_WIN), (bf16_t*)(ws + WS_WIN + 7 * MiB)};
    bf16_t* WOUT[2] = {(bf16_t*)(ws + WS_WOUT), (bf16_t*)(ws + WS_WOUT + 2 * MiB)};
    bf16_t* WUP[2] = {(bf16_t*)(ws + WS_WUP), (bf16_t*)(ws + WS_WUP + 8 * MiB)};
    bf16_t* WDN[2] = {(bf16_t*)(ws + WS_WDOWN), (bf16_t*)(ws + WS_WDOWN + 8 * MiB)};

    k_small<<<1, 256, 0, stream>>>(in[7], in[8], in[9], in[10], in[11], small);
    k_wt<<<dim3(NPAD / 32, DM / 32), 256, 0, stream>>>(in[3], DM, 3360, WIN[0]);
    k_wt<<<dim3(NPAD / 32, DM / 32), 256, 0, stream>>>(in[4], DM, 3392, WIN[1]);
    for (int l = 0; l < 2; ++l) {
        k_wt<<<dim3(DM / 32, DM / 32), 256, 0, stream>>>(in[25] + (size_t)l * DM * DM, DM, DM, WOUT[l]);
        k_wt<<<dim3(DFF / 32, DM / 32), 256, 0, stream>>>(in[28] + (size_t)l * DM * DFF, DM, DFF, WUP[l]);
        k_wt<<<dim3(DM / 32, DFF / 32), 256, 0, stream>>>(in[29] + (size_t)l * DFF * DM, DFF, DM, WDN[l]);
    }
    k_ln<<<MTOK / 4, 256, 0, stream>>>(in[0], in[1], in[2], xres, XB);
    for (int l = 0; l < 2; ++l) {
        k_gemm<0><<<dim3(NPAD / 64, MTOK / 64), 256, 0, stream>>>(XB, WIN[l], DM, P, NPAD, l ? 3392 : 3360);
        k_attn_stats<<<dim3(SEQ / 64, 8, BATCH), 64, 0, stream>>>(P, small, stats);
        k_attn_out<<<dim3(SEQ / 64, 16, BATCH), 64, 0, stream>>>(P, small, stats, SCR, l);
        k_subln<<<MTOK, 256, 0, stream>>>(SCR, small, in[12], MIX, l);
        RwParams rp;
        rp.mu = l ? in[6] : in[5]; rp.w0 = in[13] + l * 512; rp.w_up = in[14] + (size_t)l * 64 * 512; rp.a0 = in[15] + l * 512; rp.a_up = in[16] + (size_t)l * 64 * 512;
        rp.g_up = in[17] + (size_t)l * 160 * 512; rp.v0 = in[18]; rp.v_up = in[19]; rp.k_k = in[20] + l * 512; rp.k_a = in[21] + l * 512; rp.r_k = in[22] + l * 512;
        rp.gn_g = in[23] + l * 512; rp.gn_b = in[24] + l * 512;
        for (int b = 0; b < BATCH; ++b) {
            if (l == 0) k_rw_prep<0><<<SEQ / 32, 512, 0, stream>>>(P, VF, rp, SCR, b);
            else k_rw_prep<1><<<SEQ / 32, 512, 0, stream>>>(P, VF, rp, SCR, b);
            k_rw_scan<<<8, 64, 0, stream>>>(SCR, rp.gn_g, rp.gn_b, MIX, b);
        }
        k_gemm<2><<<dim3(DM / 64, MTOK / 64), 256, 0, stream>>>(MIX, WOUT[l], DM, xres, DM, DM);
        k_ln<<<MTOK / 4, 256, 0, stream>>>(xres, in[26] + l * DM, in[27] + l * DM, xres, XB);
        k_gemm<1><<<dim3(DFF / 64, MTOK / 64), 256, 0, stream>>>(XB, WUP[l], DM, HID, DFF, DFF);
        k_gemm<2><<<dim3(DM / 64, MTOK / 64), 256, 0, stream>>>(HID, WDN[l], DFF, xres, DM, DM);
        k_ln<<<MTOK / 4, 256, 0, stream>>>(xres, in[30] + l * DM, in[31] + l * DM, xres, XB);
    }
}
```
